# Optimizing an MI355X kernel written in HIP

```python
import jax, jax.numpy as jnp
from jax import lax
import numpy as np

D_MODEL = 1024
BATCH = 2
SEQ = 8192
DEPTH = 1
DEC_BATCH = 32
DEC_SEQ = 32
PAST_LEN = 1024

CHUNK = 64
N_MEM = 256
D_LRU = 512
LRU_BLOCKS = 8
LRU_BLOCK = D_LRU // LRU_BLOCKS
LRU_CONV = 4
LRU_C = 8.0
D_CONV = 256
CONV_W = 31
N_XHEADS = 4
XHEAD_DIM = 64
D_XATTN = N_XHEADS * XHEAD_DIM
D_MIX = D_LRU + D_CONV + D_XATTN
D_IN = 2 * D_LRU + 3 * D_CONV + 2 * D_XATTN
EPS = 1e-6

kernel_name = 'hybrid_lru_conformer_memory_step'


def rmsnorm(x, g):
    x32 = x.astype(jnp.float32)
    y = x32 * lax.rsqrt(jnp.mean(x32 * x32, axis=-1, keepdims=True) + EPS)
    return (y * g.astype(jnp.float32)).astype(x.dtype)


def layernorm(x, g, b):
    x32 = x.astype(jnp.float32)
    mu = jnp.mean(x32, axis=-1, keepdims=True)
    xc = x32 - mu
    y = xc * lax.rsqrt(jnp.mean(xc * xc, axis=-1, keepdims=True) + EPS)
    return (y * g.astype(jnp.float32) + b.astype(jnp.float32)).astype(x.dtype)


def causal_depthwise_conv(x, buf, w, b):
    xp = jnp.concatenate([buf.astype(x.dtype), x], axis=1)
    width, ch = w.shape
    y = lax.conv_general_dilated(
        xp, w.astype(x.dtype).reshape(width, 1, ch), window_strides=(1,), padding='VALID',
        dimension_numbers=('NWC', 'WIO', 'NWC'), feature_group_count=ch)
    return y + b.astype(x.dtype), xp[:, xp.shape[1] - (width - 1):]


def _linear_combine(left, right):
    a_l, u_l = left
    a_r, u_r = right
    return a_l * a_r, a_r * u_l + u_r


def rg_lru(x, h0, w_a, b_a, w_x, b_x, lam):
    bsz, t, _ = x.shape
    xb = x.reshape(bsz, t, LRU_BLOCKS, LRU_BLOCK)
    r = jax.nn.sigmoid((jnp.einsum('btnd,nde->btne', xb, w_a).reshape(bsz, t, D_LRU) + b_a).astype(jnp.float32))
    i = jax.nn.sigmoid((jnp.einsum('btnd,nde->btne', xb, w_x).reshape(bsz, t, D_LRU) + b_x).astype(jnp.float32))
    log_a = LRU_C * r * jax.nn.log_sigmoid(lam.astype(jnp.float32))
    a = jnp.exp(log_a)
    u = jnp.sqrt(-jnp.expm1(2.0 * log_a)) * (i * x.astype(jnp.float32))
    a_cum, u_cum = lax.associative_scan(_linear_combine, (a, u), axis=1)
    h = u_cum + a_cum * h0.astype(jnp.float32)[:, None, :]
    return h.astype(x.dtype), h[:, -1].astype(h0.dtype)


def memory_kv(mem, g_mem, w_k, w_v):
    bsz = mem.shape[0]
    m = rmsnorm(mem, g_mem)
    k = (m @ w_k).reshape(bsz, N_MEM, N_XHEADS, XHEAD_DIM)
    v = (m @ w_v).reshape(bsz, N_MEM, N_XHEADS, XHEAD_DIM)
    return k, v


def memory_attention(q, k, v):
    bsz, t, _ = q.shape
    qh = q.reshape(bsz, t, N_XHEADS, XHEAD_DIM).astype(jnp.float32)
    s = jnp.einsum('bthd,bmhd->bhtm', qh, k.astype(jnp.float32)) * (XHEAD_DIM ** -0.5)
    p = jax.nn.softmax(s, axis=-1)
    o = jnp.einsum('bhtm,bmhd->bthd', p, v.astype(jnp.float32))
    return o.reshape(bsz, t, D_XATTN).astype(q.dtype)


def hybrid_layer(x, lru_h0, lru_buf, conv_buf, mem_k, mem_v, g_norm, w_in, w_lru_conv, b_lru_conv,
                 w_gate_a, b_gate_a, w_gate_x, b_gate_x, lru_lambda, w_dw, b_dw, ln_g, ln_b,
                 w_pw, b_pw, w_out):
    h = rmsnorm(x, g_norm)
    z = h @ w_in
    splits = [D_LRU, 2 * D_LRU, 2 * D_LRU + D_CONV, 2 * D_LRU + 2 * D_CONV,
              2 * D_LRU + 3 * D_CONV, 2 * D_LRU + 3 * D_CONV + D_XATTN]
    lru_in, lru_gate, glu_a, glu_b, conv_gate, q, attn_gate = jnp.split(z, splits, axis=-1)
    xl, lru_buf_new = causal_depthwise_conv(lru_in, lru_buf, w_lru_conv, b_lru_conv)
    yl, h_last = rg_lru(xl, lru_h0, w_gate_a, b_gate_a, w_gate_x, b_gate_x, lru_lambda)
    yl = yl * jax.nn.silu(lru_gate)
    uc = glu_a * jax.nn.sigmoid(glu_b)
    uc, conv_buf_new = causal_depthwise_conv(uc, conv_buf, w_dw, b_dw)
    uc = jax.nn.silu(layernorm(uc, ln_g, ln_b))
    yc = (uc @ w_pw + b_pw) * jax.nn.silu(conv_gate)
    ya = memory_attention(q, mem_k, mem_v) * jax.nn.silu(attn_gate)
    y = jnp.concatenate([yl, yc, ya], axis=-1) @ w_out
    return x + y, h_last, lru_buf_new, conv_buf_new


def setup_inputs(seed: int = 0) -> dict:
    key = jax.random.key(seed)
    ks = jax.random.split(key, 32)
    f32 = jnp.float32
    nrm = lambda k, shape, scale: scale * jax.random.normal(k, shape, f32)
    u = jax.random.uniform(ks[15], (DEPTH, D_LRU), f32, minval=0.9, maxval=0.999)
    s = u ** (1.0 / LRU_C)
    return {
        'x_prompt': nrm(ks[0], (BATCH, SEQ, D_MODEL), 1.0),
        'x_sample': nrm(ks[1], (DEC_BATCH, DEC_SEQ, D_MODEL), 1.0),
        'state_lru_h': nrm(ks[2], (DEPTH, DEC_BATCH, D_LRU), 0.5),
        'state_lru_conv': nrm(ks[3], (DEPTH, DEC_BATCH, LRU_CONV - 1, D_LRU), 1.0),
        'state_conv': nrm(ks[4], (DEPTH, DEC_BATCH, CONV_W - 1, D_CONV), 1.0),
        'cache_mem_k': nrm(ks[5], (DEPTH, DEC_BATCH, N_MEM, N_XHEADS, XHEAD_DIM), 1.0),
        'cache_mem_v': nrm(ks[6], (DEPTH, DEC_BATCH, N_MEM, N_XHEADS, XHEAD_DIM), 1.0),
        'mem_prompt': nrm(ks[7], (BATCH, N_MEM, D_MODEL), 1.0),
        'g_norm': 1.0 + nrm(ks[8], (DEPTH, D_MODEL), 0.02),
        'w_in': nrm(ks[9], (DEPTH, D_MODEL, D_IN), D_MODEL ** -0.5),
        'w_lru_conv': nrm(ks[10], (DEPTH, LRU_CONV, D_LRU), LRU_CONV ** -0.5),
        'b_lru_conv': nrm(ks[11], (DEPTH, D_LRU), 0.02),
        'w_gate_a': nrm(ks[12], (DEPTH, LRU_BLOCKS, LRU_BLOCK, LRU_BLOCK), LRU_BLOCK ** -0.5),
        'b_gate_a': nrm(ks[13], (DEPTH, D_LRU), 0.02),
        'w_gate_x': nrm(ks[14], (DEPTH, LRU_BLOCKS, LRU_BLOCK, LRU_BLOCK), LRU_BLOCK ** -0.5),
        'b_gate_x': nrm(ks[16], (DEPTH, D_LRU), 0.02),
        'lru_lambda': jnp.log(s) - jnp.log1p(-s),
        'w_dw': nrm(ks[17], (DEPTH, CONV_W, D_CONV), CONV_W ** -0.5),
        'b_dw': nrm(ks[18], (DEPTH, D_CONV), 0.02),
        'ln_g': 1.0 + nrm(ks[19], (DEPTH, D_CONV), 0.02),
        'ln_b': nrm(ks[20], (DEPTH, D_CONV), 0.02),
        'w_pw': nrm(ks[21], (DEPTH, D_CONV, D_CONV), D_CONV ** -0.5),
        'b_pw': nrm(ks[22], (DEPTH, D_CONV), 0.02),
        'g_mem': 1.0 + nrm(ks[23], (DEPTH, D_MODEL), 0.02),
        'w_mem_k': nrm(ks[24], (DEPTH, D_MODEL, D_XATTN), D_MODEL ** -0.5),
        'w_mem_v': nrm(ks[25], (DEPTH, D_MODEL, D_XATTN), D_MODEL ** -0.5),
        'w_out': nrm(ks[26], (DEPTH, D_MIX, D_MODEL), D_MIX ** -0.5),
        'g_final': 1.0 + nrm(ks[27], (D_MODEL,), 0.02),
    }


def reference(x_prompt, x_sample, state_lru_h, state_lru_conv, state_conv, cache_mem_k, cache_mem_v,
              mem_prompt, g_norm, w_in, w_lru_conv, b_lru_conv, w_gate_a, b_gate_a, w_gate_x, b_gate_x,
              lru_lambda, w_dw, b_dw, ln_g, ln_b, w_pw, b_pw, g_mem, w_mem_k, w_mem_v, w_out, g_final):
    bp = x_prompt.shape[0]
    dt = x_prompt.dtype
    hp, hs = x_prompt, x_sample
    p_h, p_lb, p_cb, p_mk, p_mv = [], [], [], [], []
    s_h, s_lb, s_cb = [], [], []
    for l in range(DEPTH):
        mk, mv = memory_kv(mem_prompt, g_mem[l], w_mem_k[l], w_mem_v[l])
        hp, h_new, lb_new, cb_new = hybrid_layer(
            hp, jnp.zeros((bp, D_LRU), dt), jnp.zeros((bp, LRU_CONV - 1, D_LRU), dt),
            jnp.zeros((bp, CONV_W - 1, D_CONV), dt), mk, mv,
            g_norm[l], w_in[l], w_lru_conv[l], b_lru_conv[l], w_gate_a[l], b_gate_a[l], w_gate_x[l],
            b_gate_x[l], lru_lambda[l], w_dw[l], b_dw[l], ln_g[l], ln_b[l], w_pw[l], b_pw[l], w_out[l])
        p_h.append(h_new); p_lb.append(lb_new); p_cb.append(cb_new); p_mk.append(mk); p_mv.append(mv)
        hs, h_new, lb_new, cb_new = hybrid_layer(
            hs, state_lru_h[l], state_lru_conv[l], state_conv[l], cache_mem_k[l], cache_mem_v[l],
            g_norm[l], w_in[l], w_lru_conv[l], b_lru_conv[l], w_gate_a[l], b_gate_a[l], w_gate_x[l],
            b_gate_x[l], lru_lambda[l], w_dw[l], b_dw[l], ln_g[l], ln_b[l], w_pw[l], b_pw[l], w_out[l])
        s_h.append(h_new); s_lb.append(lb_new); s_cb.append(cb_new)
    y_prompt = rmsnorm(hp, g_final)
    y_sample = rmsnorm(hs, g_final)
    return (y_prompt, y_sample, jnp.stack(p_h), jnp.stack(p_lb), jnp.stack(p_cb), jnp.stack(p_mk),
            jnp.stack(p_mv), jnp.stack(s_h), jnp.stack(s_lb), jnp.stack(s_cb))
```

```cpp
#include <hip/hip_runtime.h>
#include <cstdio>
#include <cstdint>
namespace pg8 {
#define PG8_LAS __attribute__((address_space(3)))
typedef unsigned short bf16_t;
typedef short bf16x8 __attribute__((ext_vector_type(8)));
typedef float f32x4 __attribute__((ext_vector_type(4)));
typedef unsigned u32x4 __attribute__((ext_vector_type(4)));
typedef unsigned u32x2 __attribute__((ext_vector_type(2)));
constexpr int BM = 256, BK = 64, HALF = 128, HTB = HALF * BK * 2  , STAGE_BYTES = 8 * HTB, NXCD = 8, WGM = 8;

__host__ __device__ __forceinline__ int lds_byte(int r, int c) { const int st = (r >> 4) * 2 + (c >> 5), rr = r & 15, cc = c & 31, ob = rr * 64 + cc * 2; return st * 1024 + (ob ^ (((ob >> 9) & 1) << 5)); }
__host__ __device__ __forceinline__ void stage_rc(int b, int& R, int& C) { const int st = b / 1024, sb = b % 1024, swz = sb ^ (((sb >> 9) & 1) << 5); R = (st >> 1) * 16 + swz / 64; C = (st & 1) * 32 + (swz % 64) / 2; }
__host__ __device__ __forceinline__ int perm32(int rho) { const int n = rho >> 4, i = rho & 15; return 8 * (i >> 2) + 4 * n + (i & 3); }

constexpr int TM_MEM0_ = 68, TN_WK_ = 79, TM_WV_ = 80;
struct Unit { int pm, pn; };
struct Gemm { const bf16_t* A; const bf16_t* Bt; int M, N, K; };

struct StaticOrder {
    int nM, nN, nwg, G, c, pm_off, pn_off, nextra;
    __host__ __device__ void init(int nM_, int nN_, int G_, int c_, int pm_off_, int pn_off_) { nM = nM_; nN = nN_; nwg = nM * nN; G = G_; c = c_; pm_off = pm_off_; pn_off = pn_off_; nextra = 0; }
    __host__ __device__ bool next(int i, Unit& u) const {
        const long L = (long)i * G + c; if (L >= nwg + nextra) return false;
        if (L >= nwg) { const int e = (int)L - nwg; u.pm = e < 2 ? TM_MEM0_ + e : TM_WV_; u.pn = e < 2 ? TN_WK_ : TM_MEM0_ + (e - 2); return true; }
        int wgid = (int)L; { const int q = nwg / NXCD, r = nwg % NXCD, xcd = wgid % NXCD, off = wgid / NXCD; wgid = (xcd < r ? xcd * (q + 1) : r * (q + 1) + (xcd - r) * q) + off; }
        const int nig = WGM * nN, gid = wgid / nig, fm = gid * WGM, gsz = (nM - fm) < WGM ? (nM - fm) : WGM;
        u.pm = pm_off + fm + ((wgid % nig) % gsz); u.pn = pn_off + (wgid % nig) / gsz; return true;
    }
    __device__ __forceinline__ void a_ready(const Unit&) const {}
    __device__ __forceinline__ void done(const Unit&) const {}
};

__device__ __forceinline__ unsigned cvt_pk_bf16(float lo, float hi) { unsigned r; asm volatile("v_cvt_pk_bf16_f32 %0, %1, %2" : "=v"(r) : "v"(lo), "v"(hi)); return r; }

constexpr int TM_TOK = 68, TM_MEM0 = 68, TN_WIN0 = 70, TN_WK = 79, TM_WV = 80;
struct EpiZ {
    static constexpr bool PERM = true, AFTER_DRAIN = false;
    bf16_t* Z; bf16_t* KB; bf16_t* VT; float* outK; float* outV;
    __device__ __forceinline__ void operator()(const f32x4 (&acc)[2][2][4][2], const Unit& u, int wr, int wc, int fr, int fq) const {
        int r0 = wr * 64 + fr, c0 = wc * 32 + 8 * fq; asm volatile("" : "+v"(r0), "+v"(c0));
        if (u.pm < TM_TOK) {
            bf16_t* base = Z + (size_t)(u.pm * BM + r0) * 2304 + (u.pn - TN_WIN0) * BM + c0;
#pragma unroll
            for (int ai = 0; ai < 2; ++ai)
#pragma unroll
                for (int m = 0; m < 4; ++m) { bf16_t* rowp = base + (size_t)(ai * HALF + m * 16) * 2304;
#pragma unroll
                    for (int bj = 0; bj < 2; ++bj) { const f32x4 v0 = acc[ai][bj][m][0], v1 = acc[ai][bj][m][1];
                        u32x4 w; w.x = cvt_pk_bf16(v0[0], v0[1]); w.y = cvt_pk_bf16(v0[2], v0[3]); w.z = cvt_pk_bf16(v1[0], v1[1]); w.w = cvt_pk_bf16(v1[2], v1[3]);
                        *(u32x4*)(rowp + bj * HALF) = w; } }
        } else if (u.pm < TM_MEM0 + 2) {
            const int mrow0 = (u.pm - TM_MEM0) * BM + r0;
#pragma unroll
            for (int ai = 0; ai < 2; ++ai)
#pragma unroll
                for (int m = 0; m < 4; ++m) { const size_t ro = (size_t)(mrow0 + ai * HALF + m * 16) * 256 + c0;
#pragma unroll
                    for (int bj = 0; bj < 2; ++bj) { const f32x4 v0 = acc[ai][bj][m][0], v1 = acc[ai][bj][m][1];
                        u32x4 w; w.x = cvt_pk_bf16(v0[0], v0[1]); w.y = cvt_pk_bf16(v0[2], v0[3]); w.z = cvt_pk_bf16(v1[0], v1[1]); w.w = cvt_pk_bf16(v1[2], v1[3]);
                        *(u32x4*)(KB + ro + bj * HALF) = w; *(f32x4*)(outK + ro + bj * HALF) = v0; *(f32x4*)(outK + ro + bj * HALF + 4) = v1; } }
        } else {
            const int mcol0 = (u.pn - TM_MEM0) * BM + c0;
#pragma unroll
            for (int ai = 0; ai < 2; ++ai)
#pragma unroll
                for (int m = 0; m < 4; ++m) { const int hd = r0 + ai * HALF + m * 16;
#pragma unroll
                    for (int bj = 0; bj < 2; ++bj) { const f32x4 v0 = acc[ai][bj][m][0], v1 = acc[ai][bj][m][1]; const int mc = mcol0 + bj * HALF;
                        u32x4 w; w.x = cvt_pk_bf16(v0[0], v0[1]); w.y = cvt_pk_bf16(v0[2], v0[3]); w.z = cvt_pk_bf16(v1[0], v1[1]); w.w = cvt_pk_bf16(v1[2], v1[3]);
                        *(u32x4*)(VT + (size_t)hd * 512 + mc) = w;
#pragma unroll
                        for (int e = 0; e < 4; ++e) { outV[(size_t)(mc + e) * 256 + hd] = v0[e]; outV[(size_t)(mc + 4 + e) * 256 + hd] = v1[e]; } } }
        }
    }
};
struct EpiRes {
    static constexpr bool PERM = false, AFTER_DRAIN = false;
    const float* xp; const float* xs; float* out; float* ss;
    __device__ __forceinline__ void operator()(const f32x4 (&acc)[2][2][4][2], const Unit& u, int wr, int wc, int fr, int fq) const {
        int col0 = u.pn * BM + wc * 32 + 4 * fq, rowb = u.pm * BM + wr * 64 + fr; asm volatile("" : "+v"(col0), "+v"(rowb));
#pragma unroll
        for (int ai = 0; ai < 2; ++ai)
#pragma unroll
            for (int m = 0; m < 4; ++m) { const int row = rowb + ai * HALF + m * 16;
                const float* xr = (row < 16384 ? xp + (size_t)row * 1024 : xs + (size_t)(row - 16384) * 1024) + col0; float* orow = out + (size_t)row * 1024 + col0;
#pragma unroll
                for (int bj = 0; bj < 2; ++bj) { float q = 0.f;
#pragma unroll
                    for (int n = 0; n < 2; ++n) { const f32x4 v = acc[ai][bj][m][n] + *(const f32x4*)(xr + bj * HALF + n * 16); *(f32x4*)(orow + bj * HALF + n * 16) = v; q += (v[0] * v[0] + v[1] * v[1]) + (v[2] * v[2] + v[3] * v[3]); }
                    q += __shfl_xor(q, 16); q += __shfl_xor(q, 32);
                    if (fq == 0) ss[(size_t)row * 32 + u.pn * 8 + bj * 4 + wc] = q; } }
    }
};
template <class Epi, class Sched, bool ALIGN_EPI = false, bool SP2 = false>
__device__ __forceinline__ void gemm_phase(PG8_LAS unsigned char* lds, const Gemm g, const Sched& S, const Epi& E) {
    const int tid = threadIdx.x, wid = __builtin_amdgcn_readfirstlane(tid >> 6), lane = tid & 63, wr = wid >> 2, wc = wid & 3, fr = lane & 15, fq = lane >> 4;
    const int K = g.K, nt = K / BK;
    unsigned voffA[2], voffB[2];
#pragma unroll
    for (int i = 0; i < 2; ++i) { int R, C; stage_rc(tid * 16 + i * 8192, R, C); const int Rb = Epi::PERM ? ((R & ~31) + perm32(R & 31)) : R;
        voffA[i] = (unsigned)(R * K + C) * 2u; voffB[i] = (unsigned)(Rb * K + C) * 2u; }
    const size_t kstep = (size_t)(BK * 2);
    const size_t hstep = (size_t)HALF * K * 2;
    const size_t tstep = 2 * hstep;
    const unsigned ldsw = (unsigned)wid * 1024u;
    const int aoff = lds_byte(wr * 64 + fr, fq * 8), boff = lds_byte(wc * 32 + fr, fq * 8);
#define PG8_SA(b, h) (((b) * 2 + (h)) * HTB)
#define PG8_SB(b, h) ((4 + (b) * 2 + (h)) * HTB)
#define PG8_STAGE(bufoff, gbase, voff) do { _Pragma("unroll") for (int _i = 0; _i < 2; ++_i) \
        __builtin_amdgcn_global_load_lds((const unsigned*)((const char*)(gbase) + (voff)[_i]), (PG8_LAS unsigned*)(lds + (bufoff) + ldsw + _i * 8192), 16, 0, 0); } while (0)
#define PG8_LDA(dst, b, h) do { _Pragma("unroll") for (int m = 0; m < 4; ++m) _Pragma("unroll") for (int k = 0; k < 2; ++k) dst[m][k] = *(const PG8_LAS bf16x8*)(lds + PG8_SA(b, h) + aoff + m * 2048 + k * 1024); } while (0)
#define PG8_LDB(dst, b, h) do { _Pragma("unroll") for (int n = 0; n < 2; ++n) _Pragma("unroll") for (int k = 0; k < 2; ++k) dst[n][k] = *(const PG8_LAS bf16x8*)(lds + PG8_SB(b, h) + boff + n * 2048 + k * 1024); } while (0)
#define PG8_MMA(ai, bj, At, Bt) do { __builtin_amdgcn_s_setprio(1); _Pragma("unroll") for (int m = 0; m < 4; ++m) _Pragma("unroll") for (int n = 0; n < 2; ++n) _Pragma("unroll") for (int k = 0; k < 2; ++k) \
        acc[ai][bj][m][n] = __builtin_amdgcn_mfma_f32_16x16x32_bf16(Bt[n][k], At[m][k], acc[ai][bj][m][n], 0, 0, 0); __builtin_amdgcn_s_setprio(0); } while (0)
#define PG8_WAIT_V(n) asm volatile("s_waitcnt vmcnt(" #n ")" ::: "memory")
#define PG8_WAIT_L(n) asm volatile("s_waitcnt lgkmcnt(" #n ")" ::: "memory")
#define PG8_BAR __builtin_amdgcn_s_barrier()
#define PG8_SCHED __builtin_amdgcn_sched_barrier(0)
    Unit cur, nxt; int ui = 0;
    if (!S.next(0, cur)) return;
    f32x4 acc[2][2][4][2];
#pragma unroll
    for (int a = 0; a < 2; ++a)
#pragma unroll
        for (int b = 0; b < 2; ++b)
#pragma unroll
            for (int m = 0; m < 4; ++m)
#pragma unroll
                for (int n = 0; n < 2; ++n) acc[a][b][m][n] = (f32x4){0.f, 0.f, 0.f, 0.f};
    bf16x8 At[4][2], B0[2][2], B1[2][2];
    const char* cA = (const char*)g.A + (size_t)cur.pm * tstep; const char* cB = (const char*)g.Bt + (size_t)cur.pn * tstep;
    S.a_ready(cur);
    if constexpr (SP2) {
        PG8_STAGE(PG8_SB(0, 0), cB, voffB); PG8_STAGE(PG8_SB(0, 1), cB + hstep, voffB); PG8_STAGE(PG8_SA(0, 0), cA, voffA); PG8_STAGE(PG8_SA(0, 1), cA + hstep, voffA);
        if (wr == 1) PG8_BAR;
        PG8_WAIT_V(2); PG8_BAR;
        PG8_STAGE(PG8_SB(1, 0), cB + kstep, voffB); PG8_STAGE(PG8_SA(1, 0), cA + kstep, voffA); PG8_STAGE(PG8_SB(1, 1), cB + hstep + kstep, voffB);
        PG8_WAIT_V(6); PG8_BAR;
    } else {
        PG8_STAGE(PG8_SB(0, 0), cB, voffB); PG8_STAGE(PG8_SA(0, 0), cA, voffA); PG8_STAGE(PG8_SB(0, 1), cB + hstep, voffB); PG8_STAGE(PG8_SA(0, 1), cA + hstep, voffA);
        if (wr == 1) PG8_BAR;
        PG8_WAIT_V(4); PG8_BAR;
        PG8_STAGE(PG8_SB(1, 0), cB + kstep, voffB); PG8_STAGE(PG8_SA(1, 0), cA + kstep, voffA); PG8_STAGE(PG8_SB(1, 1), cB + hstep + kstep, voffB);
        PG8_WAIT_V(6); PG8_BAR;
    }
    for (;;) {
        const bool has_next = S.next(ui + 1, nxt);
        const char* nA = has_next ? (const char*)g.A + (size_t)nxt.pm * tstep : cA; const char* nB = has_next ? (const char*)g.Bt + (size_t)nxt.pn * tstep : cB;
        for (int t = 0; t < nt; t += 2) {
            const bool last = (t == nt - 2);
            const char* a1 = cA + (size_t)(t + 1) * kstep;
            const char* a2 = last ? nA : cA + (size_t)(t + 2) * kstep; const char* b2 = last ? nB : cB + (size_t)(t + 2) * kstep;
            const char* a3 = a2 + kstep; const char* b3 = b2 + kstep;
            if (last && has_next) S.a_ready(nxt);
            if constexpr (SP2) {
            PG8_LDB(B0, 0, 0); PG8_LDB(B1, 0, 1); PG8_SCHED; PG8_LDA(At, 0, 0); PG8_STAGE(PG8_SA(1, 1), a1 + hstep, voffA);
            PG8_WAIT_V(8); PG8_WAIT_L(0); PG8_BAR; PG8_MMA(0, 0, At, B0); PG8_MMA(0, 1, At, B1); PG8_BAR; PG8_SCHED;
            PG8_LDA(At, 0, 1); PG8_STAGE(PG8_SB(0, 0), b2, voffB); PG8_STAGE(PG8_SB(0, 1), b2 + hstep, voffB); PG8_STAGE(PG8_SA(0, 0), a2, voffA);
            PG8_WAIT_V(8); PG8_WAIT_L(0); PG8_BAR; PG8_MMA(1, 0, At, B0); PG8_MMA(1, 1, At, B1); PG8_BAR; PG8_SCHED;
            PG8_LDB(B0, 1, 0); PG8_LDB(B1, 1, 1); PG8_SCHED; PG8_LDA(At, 1, 0); PG8_STAGE(PG8_SA(0, 1), a2 + hstep, voffA);
            PG8_WAIT_V(8); PG8_WAIT_L(0); PG8_BAR; PG8_MMA(0, 0, At, B0); PG8_MMA(0, 1, At, B1); PG8_BAR; PG8_SCHED;
            PG8_LDA(At, 1, 1); PG8_STAGE(PG8_SB(1, 0), b3, voffB); PG8_STAGE(PG8_SB(1, 1), b3 + hstep, voffB); PG8_STAGE(PG8_SA(1, 0), a3, voffA);
            PG8_WAIT_V(8); PG8_WAIT_L(0); PG8_BAR; PG8_MMA(1, 0, At, B0); PG8_MMA(1, 1, At, B1); PG8_BAR; PG8_SCHED;
            } else {
            PG8_LDB(B0, 0, 0); PG8_SCHED; PG8_LDA(At, 0, 0); PG8_STAGE(PG8_SA(1, 1), a1 + hstep, voffA);
            PG8_WAIT_L(8); PG8_BAR; PG8_WAIT_L(0); PG8_MMA(0, 0, At, B0); PG8_BAR; PG8_SCHED;
            PG8_LDB(B1, 0, 1); PG8_STAGE(PG8_SB(0, 0), b2, voffB);
            PG8_BAR; PG8_WAIT_L(0); PG8_MMA(0, 1, At, B1); PG8_BAR;
            PG8_LDA(At, 0, 1); PG8_STAGE(PG8_SA(0, 0), a2, voffA);
            PG8_BAR; PG8_WAIT_L(0); PG8_MMA(1, 0, At, B0); PG8_BAR; PG8_SCHED;
            PG8_STAGE(PG8_SB(0, 1), b2 + hstep, voffB);
            PG8_WAIT_V(6); PG8_BAR; PG8_MMA(1, 1, At, B1); PG8_BAR;
            PG8_LDB(B0, 1, 0); PG8_SCHED; PG8_LDA(At, 1, 0); PG8_STAGE(PG8_SA(0, 1), a2 + hstep, voffA);
            PG8_WAIT_L(8); PG8_BAR; PG8_WAIT_L(0); PG8_MMA(0, 0, At, B0); PG8_BAR; PG8_SCHED;
            PG8_LDB(B1, 1, 1); PG8_STAGE(PG8_SB(1, 0), b3, voffB);
            PG8_BAR; PG8_WAIT_L(0); PG8_MMA(0, 1, At, B1); PG8_BAR;
            PG8_LDA(At, 1, 1); PG8_STAGE(PG8_SA(1, 0), a3, voffA);
            PG8_BAR; PG8_WAIT_L(0); PG8_MMA(1, 0, At, B0); PG8_BAR; PG8_SCHED;
            PG8_STAGE(PG8_SB(1, 1), b3 + hstep, voffB);
            PG8_WAIT_V(6); PG8_BAR; PG8_MMA(1, 1, At, B1); PG8_BAR;
            }
        }
        if constexpr (ALIGN_EPI) { if (wr == 0) PG8_BAR; }
        if constexpr (!Epi::AFTER_DRAIN) { E(acc, cur, wr, wc, fr, fq); S.done(cur); }
        if (!has_next) break;
#pragma unroll
        for (int a = 0; a < 2; ++a)
#pragma unroll
            for (int b = 0; b < 2; ++b)
#pragma unroll
                for (int m = 0; m < 4; ++m)
#pragma unroll
                    for (int n = 0; n < 2; ++n) acc[a][b][m][n] = (f32x4){0.f, 0.f, 0.f, 0.f};
        cur = nxt; cA = nA; cB = nB; ++ui;
        if constexpr (ALIGN_EPI) { if (wr == 1) PG8_BAR; }
    }
    PG8_WAIT_V(0);
    if constexpr (!ALIGN_EPI) { if (wr == 0) PG8_BAR; }
    PG8_BAR;
    if constexpr (Epi::AFTER_DRAIN) { E.fused(acc, cur, wr, wc, fr, fq, lds, wid, lane); S.done(cur); }
#undef PG8_SA
#undef PG8_SB
#undef PG8_STAGE
#undef PG8_LDA
#undef PG8_LDB
#undef PG8_MMA
#undef PG8_WAIT_V
#undef PG8_WAIT_L
#undef PG8_BAR
#undef PG8_SCHED
}
}

constexpr int NWAVES = 8;
#ifndef MK_N_LAUNCHES
#define MK_N_LAUNCHES 5
#endif
constexpr int N_LAUNCHES = MK_N_LAUNCHES;
constexpr int PER_PHASE = 5;
constexpr int DM = 1024, DIN = 2304, TP = 16384, TSM = 1024, TT = TP + TSM, NMEMR = 512;
constexpr int R_MEM = TT, R_WIN = TT + NMEMR, R_WK = R_WIN + DIN, R_WV = R_WK + 256, COMB_ROWS = R_WV + 256;
static_assert(R_MEM == 68 * 256 && R_WIN == 70 * 256 && R_WK == 79 * 256 && R_WV == 80 * 256, "tile map");
constexpr int ZC_LIN = 0, ZC_LGATE = 512, ZC_GA = 1024, ZC_GB = 1280, ZC_CGATE = 1536, ZC_Q = 1792, ZC_AGATE = 2048;
constexpr float EPS = 1e-6f;
constexpr size_t O_Y = 0, O_LHP = 17825792, O_LCP = 17826816, O_CP = 17829888, O_MK = 17845248, O_MV = 17976320, O_LHS = 18107392, O_LCS = 18123776, O_CS = 18172928, O_END = 18418688;
constexpr size_t MiB = 1u << 20;
constexpr size_t WS_CTL = 0, CTL_ZERO_BYTES = 1 * MiB;
constexpr size_t WS_COMB = 2 * MiB;
constexpr size_t WS_WOT = 44 * MiB;
constexpr size_t WS_WPT = 46 * MiB;
constexpr size_t WS_WGA = 46 * MiB + 256 * 1024, WS_WGX = WS_WGA + 64 * 1024;
constexpr size_t WS_KB = 47 * MiB, WS_VT = 47 * MiB + 512 * 1024;
constexpr size_t WS_KS = 48 * MiB, WS_VTS = 52 * MiB;
constexpr size_t WS_AGG = 56 * MiB;
constexpr size_t WS_SS = 57 * MiB;
constexpr size_t WS_Z = 64 * MiB;
constexpr size_t WS_MIX = 144 * MiB;
constexpr size_t WS_END = 256 * MiB;
static_assert(WS_COMB + (size_t)COMB_ROWS * 2048 <= WS_WOT && WS_SS + (size_t)TT * 128 <= WS_Z && WS_Z + (size_t)TT * DIN * 2 <= WS_MIX && WS_MIX + (size_t)TT * DM * 2 <= WS_END, "d_ws map");
constexpr int CW_TMO = 0, CW_CODE = 1, CW_BAR = 4096, CW_SEQ = 8192;
constexpr int RING_OFF = 0, RING_BYTES = 139264;
constexpr int LDSCTL_OFF = RING_BYTES, MISC_OFF = LDSCTL_OFF + 320;
constexpr int LDS_BYTES = 147456;
static_assert(MISC_OFF + 128 <= LDS_BYTES, "LDS map");

#define GAS __attribute__((address_space(1)))
#define LAS __attribute__((address_space(3)))
typedef unsigned short bf16;
typedef unsigned v4u __attribute__((ext_vector_type(4)));
typedef unsigned v2u __attribute__((ext_vector_type(2)));
typedef float f32x4 __attribute__((ext_vector_type(4)));
typedef float f32x16 __attribute__((ext_vector_type(16)));
typedef short bf16x8 __attribute__((ext_vector_type(8)));
typedef GAS unsigned gu32;
typedef GAS unsigned long long gu64;
#define RLX_AGENT __ATOMIC_RELAXED, __HIP_MEMORY_SCOPE_AGENT
#define LDS_WAIT() asm volatile("s_waitcnt lgkmcnt(0)" ::: "memory")
#define VM_WAIT() asm volatile("s_waitcnt vmcnt(0)" ::: "memory")
__device__ __forceinline__ unsigned f2bf(float f) { unsigned u = __builtin_bit_cast(unsigned, f); return (u + 0x7fffu + ((u >> 16) & 1u)) >> 16; }
__device__ __forceinline__ unsigned pk2(float lo, float hi) { return f2bf(lo) | (f2bf(hi) << 16); }
__device__ __forceinline__ float bflo(unsigned w) { return __builtin_bit_cast(float, w << 16); }
__device__ __forceinline__ float bfhi(unsigned w) { return __builtin_bit_cast(float, w & 0xffff0000u); }
__device__ __forceinline__ float sigm(float x) { return __builtin_amdgcn_rcpf(1.0f + __expf(-x)); }
__device__ __forceinline__ float wave_sum(float v) {
#pragma unroll
    for (int o = 1; o < 64; o <<= 1) v += __shfl_xor(v, o);
    return v;
}
#define XB_TMO      128
#define XB_XCNT(j)  (256  + 64 * (j))
#define XB_XSUB(j)  (1280 + 64 * (j))
#define XB_XGEN(j)  (2304 + 64 * (j))
#define XB_TOP      3328
#define XB_TOPGEN   3392
#define XCD_BAR_WORDS 3456
#define XB_SPIN_CAP (1u << 18)

__device__ __forceinline__ unsigned xb_ld(unsigned* p)              { return __hip_atomic_load(p, __ATOMIC_RELAXED, __HIP_MEMORY_SCOPE_AGENT); }
__device__ __forceinline__ unsigned xb_add(unsigned* p, unsigned v) { return __hip_atomic_fetch_add(p, v, __ATOMIC_RELAXED, __HIP_MEMORY_SCOPE_AGENT); }
__device__ __forceinline__ unsigned xb_xcc_id() { return (unsigned)__builtin_amdgcn_s_getreg((3 << 11) | 20) & 0xFu; }
#define XB_SPIN(cond, bar) do { unsigned _sp = 0; while (cond) { __builtin_amdgcn_s_sleep(1); \
    if ((++_sp & 255u) == 0u) { if (xb_ld(&(bar)[XB_TMO])) break; if (_sp > XB_SPIN_CAP) { atomicAdd(&(bar)[XB_TMO], 1u); break; } } } } while (0)

struct XcdBarrier {
    unsigned* bar; unsigned x;
    volatile LAS unsigned* st;
};

__device__ __forceinline__ XcdBarrier xcd_barrier_post(unsigned* bar, volatile LAS unsigned* st) {
    XcdBarrier b; b.bar = bar; b.x = xb_xcc_id(); b.st = st;
    if (threadIdx.x == 0) (void)xb_add(&bar[XB_XCNT(b.x)], 1u);
    return b;
}
__device__ __forceinline__ void xcd_barrier_complete(unsigned* bar, unsigned x, unsigned& nloc, unsigned& nx) {
    const unsigned G = gridDim.x * gridDim.y * gridDim.z;
    unsigned sum, cnt, mine, sp = 0u;
    for (;;) {
        sum = 0u; cnt = 0u; mine = 0u;
#pragma unroll
        for (unsigned j = 0; j < 16; ++j) { const unsigned c = xb_ld(&bar[XB_XCNT(j)]); sum += c; cnt += (c > 0u) ? 1u : 0u; mine = (j == x) ? c : mine; }
        if (sum == G) break;
        __builtin_amdgcn_s_sleep(1);
        if ((++sp & 255u) == 0u) { if (xb_ld(&bar[XB_TMO])) break; if (sp > XB_SPIN_CAP) { atomicAdd(&bar[XB_TMO], 1u); break; } }
    }
    nloc = mine > 0u ? mine : 1u; nx = cnt > 0u ? cnt : 1u;
}

__device__ __forceinline__ void xcd_barrier(const XcdBarrier& b) {
    asm volatile("s_waitcnt vmcnt(0)" ::: "memory");
    __syncthreads();
    if (threadIdx.x == 0) {
        unsigned* bar = b.bar;
        __builtin_amdgcn_s_waitcnt(0);
        unsigned nloc = b.st[0], nx = b.st[1];
        if (nloc == 0u) { xcd_barrier_complete(bar, b.x, nloc, nx); b.st[0] = nloc; b.st[1] = nx; }
        const unsigned old = xb_add(&bar[XB_XSUB(b.x)], 1u);
        const unsigned gen = old / nloc;
        if (old + 1u == (gen + 1u) * nloc) {
            __builtin_amdgcn_fence(__ATOMIC_RELEASE, "agent");
            asm volatile("s_waitcnt vmcnt(0)" ::: "memory");
            const unsigned og = xb_add(&bar[XB_TOP], 1u);
            const unsigned tg = og / nx;
            if (og + 1u == (tg + 1u) * nx) xb_add(&bar[XB_TOPGEN], 1u);
            else XB_SPIN(xb_ld(&bar[XB_TOPGEN]) == tg, bar);
            __builtin_amdgcn_fence(__ATOMIC_ACQUIRE, "agent");
            xb_add(&bar[XB_XGEN(b.x)], 1u);
            asm volatile("s_waitcnt vmcnt(0)" ::: "memory");
        } else {
            XB_SPIN(xb_ld(&bar[XB_XGEN(b.x)]) == gen, bar);
            __builtin_amdgcn_fence(__ATOMIC_ACQUIRE, "agent");
            asm volatile("s_waitcnt vmcnt(0)" ::: "memory");
        }
    }
    __syncthreads();
}


struct Frame {
    LAS unsigned char* lds;
    volatile LAS unsigned* MISC;
    gu32* ctl;
    int tid, lane, wave;
    int vcu, G;
    const float* const* in;
    float* out;
    unsigned char* ws;
    bf16 *COMB, *WOT, *WPT, *WGA, *WGX, *KB, *VT, *KS, *VTS, *Z, *MIX;
    unsigned long long* AGG; float* SS;
};
enum { I_XP = 0, I_XS, I_SLH, I_SLC, I_SC, I_CK, I_CV, I_MEM, I_GN, I_WIN, I_WLC, I_BLC, I_WGA, I_BGA, I_WGX, I_BGX, I_LAM, I_WDW, I_BDW, I_LNG, I_LNB, I_WPW, I_BPW, I_GMEM, I_WMK, I_WMV, I_WOUT, I_GF };

__device__ __forceinline__ void p0_transpose_item(const float* W, int K, int N, bf16* WT, int row_off, const float* ksc, LAS float* scr, int item, int lane) {
    const int nblk = N / 32, kb = item / nblk, nb = item % nblk, k0 = 64 * kb, n0 = 32 * nb;
#pragma unroll 8
    for (int i = 0; i < 32; ++i) { const int kk = 2 * i + (lane >> 5); float v = W[(size_t)(k0 + kk) * N + n0 + (lane & 31)]; if (ksc) v *= ksc[k0 + kk]; scr[kk * 33 + (lane & 31)] = v; }
    LDS_WAIT(); asm volatile("" ::: "memory");
    const int c = lane & 7;
#pragma unroll
    for (int j = 0; j < 4; ++j) { const int n = (lane >> 3) + 8 * j; const LAS float* s = scr + (8 * c) * 33 + n;
        v4u o; o.x = pk2(s[0 * 33], s[1 * 33]); o.y = pk2(s[2 * 33], s[3 * 33]); o.z = pk2(s[4 * 33], s[5 * 33]); o.w = pk2(s[6 * 33], s[7 * 33]);
        *(GAS v4u*)(WT + (size_t)(row_off + n0 + n) * K + k0 + 8 * c) = o; }
    LDS_WAIT(); asm volatile("" ::: "memory");
}
__device__ __forceinline__ void rms_row_to_bf16(const float* xrow, bf16* orow, int lane) {
    const GAS f32x4* xr = (const GAS f32x4*)xrow + lane;
    f32x4 v[4]; float s = 0.f;
#pragma unroll
    for (int j = 0; j < 4; ++j) { v[j] = xr[64 * j]; s += (v[j].x * v[j].x + v[j].y * v[j].y) + (v[j].z * v[j].z + v[j].w * v[j].w); }
    const float rstd = 1.0f / sqrtf(wave_sum(s) * (1.f / 1024.f) + EPS);
    GAS unsigned long long* o8 = (GAS unsigned long long*)orow + lane;
#pragma unroll
    for (int j = 0; j < 4; ++j) o8[64 * j] = (unsigned long long)pk2(v[j].x * rstd, v[j].y * rstd) | ((unsigned long long)pk2(v[j].z * rstd, v[j].w * rstd) << 32);
}
__device__ __forceinline__ void p0_prologue(Frame& F) {
    LAS float* scr = (LAS float*)(F.lds + RING_OFF + F.wave * 16384);
    const int gw = F.vcu * NWAVES + F.wave, NGW = F.G * NWAVES;
    constexpr int I0 = 16 * 72, I1 = 16 * 8, I2 = 16 * 8, I3 = 16 * 32, I4 = 4 * 8, I5 = 16, I6 = 16, I7 = 32 * 32;
    constexpr int NTR = I0 + I1 + I2 + I3 + I4 + I5 + I6 + I7, NROW = TT + NMEMR, NKC = 32 * 256 * 256 / 512;
    for (int it = gw; it < NTR + NROW + NKC; it += NGW) {
        int r = it;
        if (r < NTR) {
            if (r < I0) { p0_transpose_item(F.in[I_WIN], 1024, DIN, F.COMB, R_WIN, F.in[I_GN], scr, r, F.lane); continue; } r -= I0;
            if (r < I1) { p0_transpose_item(F.in[I_WMK], 1024, 256, F.COMB, R_WK, F.in[I_GMEM], scr, r, F.lane); continue; } r -= I1;
            if (r < I2) { p0_transpose_item(F.in[I_WMV], 1024, 256, F.COMB, R_WV, F.in[I_GMEM], scr, r, F.lane); continue; } r -= I2;
            if (r < I3) { p0_transpose_item(F.in[I_WOUT], 1024, 1024, F.WOT, 0, nullptr, scr, r, F.lane); continue; } r -= I3;
            if (r < I4) { p0_transpose_item(F.in[I_WPW], 256, 256, F.WPT, 0, nullptr, scr, r, F.lane); continue; } r -= I4;
            if (r < I5) { p0_transpose_item(F.in[I_WGA] + (r >> 1) * 4096, 64, 64, F.WGA + (r >> 1) * 4096, 0, nullptr, scr, r & 1, F.lane); continue; } r -= I5;
            if (r < I6) { p0_transpose_item(F.in[I_WGX] + (r >> 1) * 4096, 64, 64, F.WGX + (r >> 1) * 4096, 0, nullptr, scr, r & 1, F.lane); continue; } r -= I6;
            p0_transpose_item(F.in[I_CV] + (size_t)(r >> 5) * 65536, 256, 256, F.VTS + (size_t)(r >> 5) * 65536, 0, nullptr, scr, r & 31, F.lane); continue;
        }
        r -= NTR;
        if (r < NROW) {
            const float* src = r < TP ? F.in[I_XP] + (size_t)r * 1024 : (r < TT ? F.in[I_XS] + (size_t)(r - TP) * 1024 : F.in[I_MEM] + (size_t)(r - TT) * 1024);
            rms_row_to_bf16(src, F.COMB + (size_t)r * 1024, F.lane); continue;
        }
        r -= NROW;
        { const GAS f32x4* s = (const GAS f32x4*)(F.in[I_CK] + (size_t)r * 512) + 2 * F.lane; const f32x4 a = s[0], b = s[1];
          v4u o; o.x = pk2(a.x, a.y); o.y = pk2(a.z, a.w); o.z = pk2(b.x, b.y); o.w = pk2(b.z, b.w); *((GAS v4u*)(F.KS + (size_t)r * 512) + F.lane) = o; }
    }
}

__device__ __forceinline__ f32x4 mfma16(bf16x8 a, bf16x8 b, f32x4 c) { return __builtin_amdgcn_mfma_f32_16x16x32_bf16(a, b, c, 0, 0, 0); }
__device__ __forceinline__ f32x16 mfma32(bf16x8 a, bf16x8 b, f32x16 c) { return __builtin_amdgcn_mfma_f32_32x32x16_bf16(a, b, c, 0, 0, 0); }
__device__ __forceinline__ bf16x8 as_bf16x8(v4u v) { return __builtin_bit_cast(bf16x8, v); }

template <bool SAMPLE>
__device__ __forceinline__ void lru_unit(Frame& F, int uidx) {
    constexpr int T = SAMPLE ? 32 : 64, MT = T / 16, PIT = 1040;
    LAS unsigned char* inT = F.lds; LAS unsigned char* gT = F.lds + (T + 3) * PIT;
    int tid = F.tid; asm volatile("" : "+v"(tid));
    const int lane = tid & 63, w = F.wave, fr = lane & 15, fq = lane >> 4;
    const int seq = SAMPLE ? uidx : (uidx >> 7), t0 = SAMPLE ? 0 : (uidx & 127) * 64;
    const size_t row0 = SAMPLE ? (size_t)(TP + uidx * 32) : (size_t)uidx * 64;
    const bool last = SAMPLE ? true : ((uidx & 127) == 127);
    float* const o_lc = F.out + (SAMPLE ? O_LCS : O_LCP), * const o_lh = F.out + (SAMPLE ? O_LHS : O_LHP);
    for (int idx = tid; idx < (T + 3) * 64; idx += 512) { const int r = idx >> 6, ch = idx & 63, tr = t0 - 3 + r; v4u v = (v4u){0u, 0u, 0u, 0u};
        if (tr >= 0) v = *(const GAS v4u*)(F.Z + (row0 + r - 3) * DIN + ZC_LIN + ch * 8);
        else if (SAMPLE) { const GAS f32x4* s = (const GAS f32x4*)(F.in[I_SLC] + (size_t)(seq * 3 + r) * 512 + ch * 8); const f32x4 a = s[0], b = s[1]; v.x = pk2(a.x, a.y); v.y = pk2(a.z, a.w); v.z = pk2(b.x, b.y); v.w = pk2(b.z, b.w); }
        *(LAS v4u*)(inT + r * PIT + ch * 16) = v;
        if (last && r >= T) { GAS f32x4* o = (GAS f32x4*)(o_lc + (size_t)(seq * 3 + (r - T)) * 512 + ch * 8); o[0] = (f32x4){bflo(v.x), bfhi(v.x), bflo(v.y), bfhi(v.y)}; o[1] = (f32x4){bflo(v.z), bfhi(v.z), bflo(v.w), bfhi(v.w)}; } }
    for (int idx = tid; idx < T * 64; idx += 512) { const int r = idx >> 6, ch = idx & 63; *(LAS v4u*)(gT + r * PIT + ch * 16) = *(const GAS v4u*)(F.Z + (row0 + r) * DIN + ZC_LGATE + ch * 8); }
    __syncthreads();
    bf16x8 Af[MT][2];
#pragma unroll
    for (int ks = 0; ks < 2; ++ks) { const int cb = 64 * w + 32 * ks + 8 * fq; float wv[4][8], bv[8];
#pragma unroll
        for (int j = 0; j < 4; ++j) { const GAS f32x4* p = (const GAS f32x4*)(F.in[I_WLC] + j * 512 + cb); const f32x4 a = p[0], b = p[1]; wv[j][0] = a.x; wv[j][1] = a.y; wv[j][2] = a.z; wv[j][3] = a.w; wv[j][4] = b.x; wv[j][5] = b.y; wv[j][6] = b.z; wv[j][7] = b.w; }
        { const GAS f32x4* p = (const GAS f32x4*)(F.in[I_BLC] + cb); const f32x4 a = p[0], b = p[1]; bv[0] = a.x; bv[1] = a.y; bv[2] = a.z; bv[3] = a.w; bv[4] = b.x; bv[5] = b.y; bv[6] = b.z; bv[7] = b.w; }
#pragma unroll
        for (int m = 0; m < MT; ++m) { const int t = 16 * m + fr; float x[8];
#pragma unroll
            for (int e = 0; e < 8; ++e) x[e] = bv[e];
#pragma unroll
            for (int j = 0; j < 4; ++j) { const v4u q = *(const LAS v4u*)(inT + (t + j) * PIT + cb * 2);
                x[0] += wv[j][0] * bflo(q.x); x[1] += wv[j][1] * bfhi(q.x); x[2] += wv[j][2] * bflo(q.y); x[3] += wv[j][3] * bfhi(q.y);
                x[4] += wv[j][4] * bflo(q.z); x[5] += wv[j][5] * bfhi(q.z); x[6] += wv[j][6] * bflo(q.w); x[7] += wv[j][7] * bfhi(q.w); }
            v4u o; o.x = pk2(x[0], x[1]); o.y = pk2(x[2], x[3]); o.z = pk2(x[4], x[5]); o.w = pk2(x[6], x[7]); Af[m][ks] = as_bf16x8(o); } }
    LDS_WAIT(); asm volatile("" ::: "memory"); __builtin_amdgcn_sched_barrier(0);
#pragma unroll
    for (int m = 0; m < MT; ++m)
#pragma unroll
        for (int ks = 0; ks < 2; ++ks) *(LAS bf16x8*)(inT + (16 * m + fr + 3) * PIT + (64 * w + 32 * ks + 8 * fq) * 2) = Af[m][ks];
    LDS_WAIT(); asm volatile("" ::: "memory"); __builtin_amdgcn_sched_barrier(0);
    float Acum[4][MT][4], Hloc[4][MT][4], Arun[4], Hrun[4];
#pragma unroll
    for (int nt = 0; nt < 4; ++nt) { const int c = 64 * w + 16 * nt + fr;
        bf16x8 Ba[2], Bx[2];
#pragma unroll
        for (int ks = 0; ks < 2; ++ks) { Ba[ks] = *(const GAS bf16x8*)(F.WGA + (size_t)c * 64 + 32 * ks + 8 * fq); Bx[ks] = *(const GAS bf16x8*)(F.WGX + (size_t)c * 64 + 32 * ks + 8 * fq); }
        const float ba = F.in[I_BGA][c], bx = F.in[I_BGX][c], ls8 = -8.0f * log1pf(__expf(-F.in[I_LAM][c]));
        float ar = 1.f, hr = 0.f;
#pragma unroll
        for (int m = 0; m < MT; ++m) { f32x4 ca = (f32x4){0.f, 0.f, 0.f, 0.f}, cx = ca;
#pragma unroll
            for (int ks = 0; ks < 2; ++ks) { const bf16x8 A = *(const LAS bf16x8*)(inT + (16 * m + fr + 3) * PIT + (64 * w + 32 * ks + 8 * fq) * 2); ca = mfma16(A, Ba[ks], ca); cx = mfma16(A, Bx[ks], cx); }
            float al[4], hl[4];
#pragma unroll
            for (int rg = 0; rg < 4; ++rg) { const int t = 16 * m + 4 * fq + rg;
                const float r = sigm(ca[rg] + ba), ig = sigm(cx[rg] + bx), la = ls8 * r, a = __expf(la), x2 = la + la;
                const float poly = -x2 * (1.f + x2 * (0.5f + x2 * (0.16666667f + x2 * (0.041666668f + x2 * (0.0083333338f + x2 * 0.0013888889f)))));
                const float om = x2 > -0.3f ? poly : 1.f - __expf(x2);
                const float xl = bflo((unsigned)*(const LAS unsigned short*)(inT + (t + 3) * PIT + c * 2));
                const float u = sqrtf(om) * ig * xl;
                if (rg == 0) { al[0] = a; hl[0] = u; } else { al[rg] = a * al[rg - 1]; hl[rg] = a * hl[rg - 1] + u; } }
            const float A0 = __shfl(al[3], fr), U0 = __shfl(hl[3], fr), A1 = __shfl(al[3], fr + 16), U1 = __shfl(hl[3], fr + 16), A2 = __shfl(al[3], fr + 32), U2 = __shfl(hl[3], fr + 32);
            float EA = 1.f, EU = 0.f;
            if (fq >= 1) { EA = A0; EU = U0; }
            if (fq >= 2) { EU = A1 * EU + U1; EA = A1 * EA; }
            if (fq >= 3) { EU = A2 * EU + U2; EA = A2 * EA; }
            const float PA = EA * ar, PH = EA * hr + EU;
#pragma unroll
            for (int rg = 0; rg < 4; ++rg) { Acum[nt][m][rg] = al[rg] * PA; Hloc[nt][m][rg] = al[rg] * PH + hl[rg]; }
            ar = __shfl(Acum[nt][m][3], fr + 48); hr = __shfl(Hloc[nt][m][3], fr + 48); }
        Arun[nt] = ar; Hrun[nt] = hr; asm volatile("" ::: "memory"); }
    float hin[4];
    if (!SAMPLE) {
        if (fq == 0) {
#pragma unroll
            for (int nt = 0; nt < 4; ++nt) __hip_atomic_store((gu64*)F.AGG + (size_t)uidx * 512 + 64 * w + 16 * nt + fr,
                ((unsigned long long)__builtin_bit_cast(unsigned, Hrun[nt]) << 32) | __builtin_bit_cast(unsigned, Arun[nt]), RLX_AGENT); }
        VM_WAIT(); __syncthreads();
        {
            if (tid == 0) { gu32* cnt = F.ctl + CW_SEQ + 64 * seq; __hip_atomic_fetch_add(cnt, 1u, RLX_AGENT);
                unsigned sp = 0; while (__hip_atomic_load(cnt, RLX_AGENT) < 128u) { __builtin_amdgcn_s_sleep(2); if (++sp > (1u << 22)) { __hip_atomic_store(F.ctl + CW_TMO, 1u, RLX_AGENT); break; } } }
            __syncthreads();
        }
        float h = 0.f; const int j0 = seq * 128;
        for (int j = j0; j < uidx; j += 8) { unsigned long long v[8];
#pragma unroll
            for (int e = 0; e < 8; ++e) v[e] = (j + e < uidx) ? __hip_atomic_load((gu64*)F.AGG + (size_t)(j + e) * 512 + 64 * w + lane, RLX_AGENT) : 0x3f800000ull;
#pragma unroll
            for (int e = 0; e < 8; ++e) h = __builtin_bit_cast(float, (unsigned)v[e]) * h + __builtin_bit_cast(float, (unsigned)(v[e] >> 32)); }
#pragma unroll
        for (int nt = 0; nt < 4; ++nt) hin[nt] = __shfl(h, 16 * nt + fr);
    } else {
#pragma unroll
        for (int nt = 0; nt < 4; ++nt) hin[nt] = F.in[I_SLH][(size_t)seq * 512 + 64 * w + 16 * nt + fr];
    }
#pragma unroll
    for (int nt = 0; nt < 4; ++nt) { const int c = 64 * w + 16 * nt + fr;
#pragma unroll
        for (int m = 0; m < MT; ++m)
#pragma unroll
            for (int rg = 0; rg < 4; ++rg) { const int t = 16 * m + 4 * fq + rg; LAS unsigned short* gp = (LAS unsigned short*)(gT + t * PIT + c * 2);
                const float g = bflo((unsigned)*gp), h = Hloc[nt][m][rg] + Acum[nt][m][rg] * hin[nt]; *gp = (unsigned short)f2bf(h * g * sigm(g)); }
        if (last && fq == 0) o_lh[(size_t)seq * 512 + c] = Arun[nt] * hin[nt] + Hrun[nt]; }
    __syncthreads();
    for (int idx = tid; idx < T * 64; idx += 512) { const int r = idx >> 6, ch = idx & 63; *(GAS v4u*)(F.MIX + (row0 + r) * DM + ch * 8) = *(const LAS v4u*)(gT + r * PIT + ch * 16); }
    __syncthreads();
}

template <bool SAMPLE>
__device__ __forceinline__ void conv_unit(Frame& F, int uidx) {
    constexpr int T = SAMPLE ? 32 : 64, MT = T / 16, R = T + 30, APIT = 528, HT = T / 2;
    LAS float* ucT = (LAS float*)F.lds; LAS unsigned char* aT = F.lds + 94 * 1024;
    int tid = F.tid; asm volatile("" : "+v"(tid));
    const int lane = tid & 63, w = F.wave, fr = lane & 15, fq = lane >> 4;
    const int seq = SAMPLE ? uidx : (uidx >> 7), t0 = SAMPLE ? 0 : (uidx & 127) * 64;
    const size_t row0 = SAMPLE ? (size_t)(TP + uidx * 32) : (size_t)uidx * 64;
    const bool last = SAMPLE ? true : ((uidx & 127) == 127);
    float* const o_c = F.out + (SAMPLE ? O_CS : O_CP);
    for (int idx = tid; idx < R * 32; idx += 512) { const int r = idx >> 5, ch = idx & 31, tr = t0 - 30 + r; f32x4 u0 = (f32x4){0.f, 0.f, 0.f, 0.f}, u1 = u0;
        if (tr >= 0) { const bf16* zp = F.Z + (row0 + r - 30) * DIN + ch * 8; const v4u a = *(const GAS v4u*)(zp + ZC_GA), b = *(const GAS v4u*)(zp + ZC_GB);
            u0 = (f32x4){bflo(a.x) * sigm(bflo(b.x)), bfhi(a.x) * sigm(bfhi(b.x)), bflo(a.y) * sigm(bflo(b.y)), bfhi(a.y) * sigm(bfhi(b.y))};
            u1 = (f32x4){bflo(a.z) * sigm(bflo(b.z)), bfhi(a.z) * sigm(bfhi(b.z)), bflo(a.w) * sigm(bflo(b.w)), bfhi(a.w) * sigm(bfhi(b.w))}; }
        else if (SAMPLE) { const GAS f32x4* s = (const GAS f32x4*)(F.in[I_SC] + (size_t)(seq * 30 + r) * 256 + ch * 8); u0 = s[0]; u1 = s[1]; }
        LAS f32x4* d = (LAS f32x4*)(ucT + r * 256 + ch * 8); d[0] = u0; d[1] = u1;
        if (last && r >= T) { GAS f32x4* o = (GAS f32x4*)(o_c + (size_t)(seq * 30 + (r - T)) * 256 + ch * 8); o[0] = u0; o[1] = u1; } }
    __syncthreads();
    {
        const int c = tid & 255, tb = (tid >> 8) * HT; float wt[31];
#pragma unroll
        for (int j = 0; j < 31; ++j) wt[j] = F.in[I_WDW][j * 256 + c];
        const float bd = F.in[I_BDW][c]; float y[HT];
#pragma unroll
        for (int blk = 0; blk < HT / 8; ++blk) { float x[38];
#pragma unroll
            for (int i = 0; i < 38; ++i) x[i] = ucT[(tb + 8 * blk + i) * 256 + c];
#pragma unroll
            for (int o = 0; o < 8; ++o) { float s = bd;
#pragma unroll
                for (int j = 0; j < 31; ++j) s += wt[j] * x[o + j];
                y[8 * blk + o] = s; } }
        __syncthreads();
#pragma unroll
        for (int o = 0; o < HT; ++o) ucT[(tb + o) * 256 + c] = y[o];
    }
    __syncthreads();
    {
        const f32x4 lg = *((const GAS f32x4*)F.in[I_LNG] + lane), lb = *((const GAS f32x4*)F.in[I_LNB] + lane);
        for (int t = w * (T / 8); t < (w + 1) * (T / 8); ++t) { f32x4 x = *((const LAS f32x4*)(ucT + t * 256) + lane);
            const float mu = wave_sum((x.x + x.y) + (x.z + x.w)) * (1.f / 256.f); x = x - mu;
            const float rstd = 1.0f / sqrtf(wave_sum((x.x * x.x + x.y * x.y) + (x.z * x.z + x.w * x.w)) * (1.f / 256.f) + EPS);
            f32x4 v = x * rstd * lg + lb; v = (f32x4){v.x * sigm(v.x), v.y * sigm(v.y), v.z * sigm(v.z), v.w * sigm(v.w)};
            v2u o; o.x = pk2(v.x, v.y); o.y = pk2(v.z, v.w); *(LAS v2u*)(aT + t * APIT + lane * 8) = o; }
    }
    __syncthreads();
    {
        f32x4 acc[MT][2];
#pragma unroll
        for (int m = 0; m < MT; ++m) { acc[m][0] = (f32x4){0.f, 0.f, 0.f, 0.f}; acc[m][1] = acc[m][0]; }
#pragma unroll
        for (int ks = 0; ks < 8; ++ks) { bf16x8 Bf[2];
#pragma unroll
            for (int nt = 0; nt < 2; ++nt) Bf[nt] = *(const GAS bf16x8*)(F.WPT + (size_t)(32 * w + 16 * nt + fr) * 256 + 32 * ks + 8 * fq);
#pragma unroll
            for (int m = 0; m < MT; ++m) { const bf16x8 A = *(const LAS bf16x8*)(aT + (16 * m + fr) * APIT + (32 * ks + 8 * fq) * 2);
                acc[m][0] = mfma16(Bf[0], A, acc[m][0]); acc[m][1] = mfma16(Bf[1], A, acc[m][1]); } }
#pragma unroll
        for (int m = 0; m < MT; ++m)
#pragma unroll
            for (int nt = 0; nt < 2; ++nt) { const int n = 32 * w + 16 * nt + 4 * fq; const size_t row = row0 + 16 * m + fr;
                const f32x4 bp = *(const GAS f32x4*)(F.in[I_BPW] + n); const v2u g = *(const GAS v2u*)(F.Z + row * DIN + ZC_CGATE + n);
                const float g0 = bflo(g.x), g1 = bfhi(g.x), g2 = bflo(g.y), g3 = bfhi(g.y); const f32x4 v = acc[m][nt] + bp;
                v2u o; o.x = pk2(v.x * g0 * sigm(g0), v.y * g1 * sigm(g1)); o.y = pk2(v.z * g2 * sigm(g2), v.w * g3 * sigm(g3));
                *(GAS v2u*)(F.MIX + row * DM + 512 + n) = o; }
    }
    __syncthreads();
}

__device__ __forceinline__ void attn_unit(Frame& F, int uidx, bool sample) {
    int lane = F.lane; asm volatile("" : "+v"(lane));
    const int w = F.wave, head = w & 3, half = w >> 2, r = lane & 31, h = lane >> 5;
    size_t rowq; const bf16* Kb; const bf16* Vt; int vpit;
    if (!sample) { const int seq = uidx >> 7; rowq = (size_t)uidx * 64 + half * 32 + r; Kb = F.KB + (size_t)seq * 65536; Vt = F.VT + seq * 256; vpit = 512; }
    else { const int sq = 2 * uidx + half; rowq = (size_t)TP + sq * 32 + r; Kb = F.KS + (size_t)sq * 65536; Vt = F.VTS + (size_t)sq * 65536; vpit = 256; }
    bf16x8 Qf[4];
#pragma unroll
    for (int ks = 0; ks < 4; ++ks) Qf[ks] = *(const GAS bf16x8*)(F.Z + rowq * DIN + ZC_Q + head * 64 + 16 * ks + 8 * h);
    const int kperm = (r & 16) | (((r >> 2) & 1) << 3) | (((r >> 3) & 1) << 2) | (r & 3);
    f32x16 S[8];
#pragma unroll
    for (int kt = 0; kt < 8; ++kt) { f32x16 s;
#pragma unroll
        for (int e = 0; e < 16; ++e) s[e] = 0.f;
#pragma unroll
        for (int ks = 0; ks < 4; ++ks) { const bf16x8 Kf = *(const GAS bf16x8*)(Kb + (size_t)(32 * kt + kperm) * 256 + head * 64 + 16 * ks + 8 * h); s = mfma32(Kf, Qf[ks], s); }
        S[kt] = s; }
    float mx = -3.0e38f;
#pragma unroll
    for (int kt = 0; kt < 8; ++kt)
#pragma unroll
        for (int e = 0; e < 16; ++e) mx = fmaxf(mx, S[kt][e]);
    mx = fmaxf(mx, __shfl_xor(mx, 32));
    const float sc = 0.125f * 1.44269504f; float l = 0.f;
#pragma unroll
    for (int kt = 0; kt < 8; ++kt)
#pragma unroll
        for (int e = 0; e < 16; ++e) { const float p = __builtin_amdgcn_exp2f((S[kt][e] - mx) * sc); S[kt][e] = p; l += p; }
    l += __shfl_xor(l, 32);
    f32x16 O[2];
#pragma unroll
    for (int e = 0; e < 16; ++e) { O[0][e] = 0.f; O[1][e] = 0.f; }
#pragma unroll
    for (int kt = 0; kt < 8; ++kt)
#pragma unroll
        for (int s = 0; s < 2; ++s) { v4u pw; pw.x = pk2(S[kt][8 * s + 0], S[kt][8 * s + 1]); pw.y = pk2(S[kt][8 * s + 2], S[kt][8 * s + 3]); pw.z = pk2(S[kt][8 * s + 4], S[kt][8 * s + 5]); pw.w = pk2(S[kt][8 * s + 6], S[kt][8 * s + 7]);
            const bf16x8 Pf = as_bf16x8(pw);
#pragma unroll
            for (int dt = 0; dt < 2; ++dt) { const bf16x8 Vf = *(const GAS bf16x8*)(Vt + (size_t)(head * 64 + 32 * dt + r) * vpit + 32 * kt + 16 * s + 8 * h); O[dt] = mfma32(Vf, Pf, O[dt]); } }
    const float inv = 1.0f / l;
#pragma unroll
    for (int dt = 0; dt < 2; ++dt)
#pragma unroll
        for (int g = 0; g < 4; ++g) { const int d0 = head * 64 + 32 * dt + 8 * g + 4 * h; const v2u gz = *(const GAS v2u*)(F.Z + rowq * DIN + ZC_AGATE + d0);
            const float g0 = bflo(gz.x), g1 = bfhi(gz.x), g2 = bflo(gz.y), g3 = bfhi(gz.y);
            v2u o; o.x = pk2(O[dt][4 * g + 0] * inv * g0 * sigm(g0), O[dt][4 * g + 1] * inv * g1 * sigm(g1)); o.y = pk2(O[dt][4 * g + 2] * inv * g2 * sigm(g2), O[dt][4 * g + 3] * inv * g3 * sigm(g3));
            *(GAS v2u*)(F.MIX + rowq * DM + 768 + d0) = o; }
}

__device__ __forceinline__ void p4_final_norm(Frame& F) {
    const int gw = F.vcu * NWAVES + F.wave, NGW = F.G * NWAVES, lane = F.lane;
    f32x4 gf[4];
#pragma unroll
    for (int j = 0; j < 4; ++j) gf[j] = *((const GAS f32x4*)F.in[I_GF] + lane + 64 * j);
    for (int m = gw; m < TT; m += NGW) { GAS f32x4* o = (GAS f32x4*)(F.out + O_Y + (size_t)m * 1024) + lane;
        float s = (lane < 32) ? F.SS[(size_t)m * 32 + lane] : 0.f; s = wave_sum(s);
        const float rstd = 1.0f / sqrtf(s * (1.f / 1024.f) + EPS);
#pragma unroll
        for (int j = 0; j < 4; ++j) { const f32x4 v = o[64 * j]; o[64 * j] = v * rstd * gf[j]; } }
}

struct Args { const float* in[28]; float* out; unsigned char* ws; int ph_lo, ph_hi; };
__global__ void __launch_bounds__(NWAVES * 64, 2) skel_fwd(Args args) {
    extern __shared__ __attribute__((aligned(16))) unsigned char lds[];
    Frame F;
    F.lds = (LAS unsigned char*)lds;
    F.MISC = (volatile LAS unsigned*)(F.lds + MISC_OFF);
    F.tid = threadIdx.x; F.lane = F.tid & 63; F.wave = __builtin_amdgcn_readfirstlane(F.tid >> 6);
    F.G = gridDim.x; { const int bx = blockIdx.x; F.vcu = (F.G % 8 == 0) ? (bx % 8) * (F.G / 8) + bx / 8 : bx; }
    unsigned char* ws = args.ws; F.ws = ws;
    F.ctl = (gu32*)(ws + WS_CTL);
    F.in = args.in;
    F.out = args.out;
    F.COMB = (bf16*)(ws + WS_COMB); F.WOT = (bf16*)(ws + WS_WOT); F.WPT = (bf16*)(ws + WS_WPT); F.WGA = (bf16*)(ws + WS_WGA); F.WGX = (bf16*)(ws + WS_WGX);
    F.KB = (bf16*)(ws + WS_KB); F.VT = (bf16*)(ws + WS_VT); F.KS = (bf16*)(ws + WS_KS); F.VTS = (bf16*)(ws + WS_VTS); F.Z = (bf16*)(ws + WS_Z); F.MIX = (bf16*)(ws + WS_MIX);
    F.AGG = (unsigned long long*)(ws + WS_AGG); F.SS = (float*)(ws + WS_SS);
    for (int u = F.tid; u < (LDS_BYTES - LDSCTL_OFF) / 4; u += NWAVES * 64) ((LAS unsigned*)(F.lds + LDSCTL_OFF))[u] = 0u;
    __syncthreads();
    XcdBarrier bar; bar.bar = (unsigned*)(F.ctl + CW_BAR); bar.x = 0; bar.st = nullptr;
    if (N_LAUNCHES == 1) bar = xcd_barrier_post((unsigned*)(F.ctl + CW_BAR), F.MISC + 8);
#define GRID_BAR(seam) do { if (N_LAUNCHES != 1) { if (F.tid == 0) __hip_atomic_store(F.ctl + CW_TMO, 0xBADBA0u | (unsigned)(seam), RLX_AGENT); } else { xcd_barrier(bar); } } while (0)
    const int lo = args.ph_lo, hi = args.ph_hi;
#define IN(k) (lo <= (k) && (k) < hi)
#define BOTH(k) (IN(k) && IN((k) + 1))

    if (IN(0)) { p0_prologue(F); if (BOTH(0)) GRID_BAR(0); }

    if (IN(1)) {
        pg8::Gemm g{F.COMB, F.COMB, COMB_ROWS, COMB_ROWS, DM};
        pg8::StaticOrder S; S.init(68, 9, F.G, (int)blockIdx.x, 0, pg8::TN_WIN0);
        S.nextra = 4;
        pg8::EpiZ E{F.Z, F.KB, F.VT, F.out + O_MK, F.out + O_MV};
        pg8::gemm_phase<pg8::EpiZ, pg8::StaticOrder, true, true>(F.lds + RING_OFF, g, S, E);
        if (BOTH(1)) GRID_BAR(1);
    }

    if (IN(2)) {
        if (F.G == 256) {
            const int b = blockIdx.x;
#ifndef NO_LRU
            lru_unit<false>(F, b);
#endif
#ifndef NO_CONV
            conv_unit<false>(F, b);
#endif
#ifndef NO_ATTN
            attn_unit(F, b, false);
#endif
            if (b < 32) {
#ifndef NO_LRU
                lru_unit<true>(F, b);
#endif
            } else if (b < 64) {
#ifndef NO_CONV
                conv_unit<true>(F, b - 32);
#endif
            } else if (b < 80) {
#ifndef NO_ATTN
                attn_unit(F, b - 64, true);
#endif
            }
        } else if (F.tid == 0) __hip_atomic_store(F.ctl + CW_TMO, 0x7f0u, RLX_AGENT);
        if (BOTH(2)) GRID_BAR(2);
    }

    if (IN(3)) {
        pg8::Gemm g{F.MIX, F.WOT, TT, DM, DM};
        pg8::StaticOrder S; S.init(68, 4, F.G, (int)blockIdx.x, 0, 0);
        pg8::EpiRes E{F.in[I_XP], F.in[I_XS], F.out + O_Y, F.SS};
        pg8::gemm_phase<pg8::EpiRes, pg8::StaticOrder, true, true>(F.lds + RING_OFF, g, S, E);
        if (BOTH(3)) GRID_BAR(3);
    }

    if (IN(4)) p4_final_norm(F);
#undef IN
#undef BOTH
}

extern "C" void kernel_launch(void* const* d_in, const int* in_sizes, int n_in, void* d_out, int out_size, void* d_ws, size_t ws_size, hipStream_t stream) {
    static int grid = 0;
    if (grid == 0) {
        if (n_in != 28 || out_size != (int)O_END || ws_size < WS_END) { fprintf(stderr, "kernel_launch: unexpected shapes (n_in %d, out %d, ws %zu); nothing launched\n", n_in, out_size, ws_size); grid = -1; return; }
        int dev = 0, cus = 0, per_cu = 0;
        if (hipGetDevice(&dev) != hipSuccess || hipDeviceGetAttribute(&cus, hipDeviceAttributeMultiprocessorCount, dev) != hipSuccess) { grid = -1; return; }
        if (hipFuncSetAttribute((const void*)skel_fwd, hipFuncAttributeMaxDynamicSharedMemorySize, LDS_BYTES) != hipSuccess) { fprintf(stderr, "kernel_launch: hipFuncSetAttribute failed\n"); grid = -1; return; }
        if (hipOccupancyMaxActiveBlocksPerMultiprocessor(&per_cu, (const void*)skel_fwd, NWAVES * 64, LDS_BYTES) != hipSuccess || per_cu < 1) { fprintf(stderr, "kernel_launch: occupancy query says %d blocks per CU\n", per_cu); (void)hipGetLastError(); grid = -1; return; }
        grid = cus;
        if (grid != 256) fprintf(stderr, "kernel_launch: %d CUs; the mixer phase needs exactly 256 workgroups\n", grid);
    }
    if (grid < 0) return;
    if (hipMemsetAsync((char*)d_ws + WS_CTL, 0, CTL_ZERO_BYTES, stream) != hipSuccess) return;
    Args a{};
    for (int i = 0; i < 28; ++i) a.in[i] = (const float*)d_in[i];
    a.out = (float*)d_out; a.ws = (unsigned char*)d_ws;
    if (N_LAUNCHES == 1) {
        a.ph_lo = 0; a.ph_hi = PER_PHASE;
        void* kargs[] = {&a};
        const hipError_t le = hipLaunchCooperativeKernel((const void*)skel_fwd, dim3(grid), dim3(NWAVES * 64), kargs, LDS_BYTES, stream);
        if (le != hipSuccess) fprintf(stderr, "kernel_launch: cooperative launch failed: %s (grid %d)\n", hipGetErrorName(le), grid);
    } else {
        for (int li = 0; li < PER_PHASE; ++li) { a.ph_lo = li; a.ph_hi = li + 1;
            hipLaunchKernelGGL(skel_fwd, dim3(grid), dim3(NWAVES * 64), LDS_BYTES, stream, a);
            const hipError_t le = hipPeekAtLastError(); if (le != hipSuccess) { fprintf(stderr, "kernel_launch: launch %d failed: %s\n", li, hipGetErrorName(le)); break; } }
    }
}
```
